# Optimizing an MI355X kernel written in HIP

```python
import jax, jax.numpy as jnp
from jax import lax
import numpy as np

D_MODEL = 1024
BATCH = 16
SEQ = 256
DEPTH = 4
DEC_BATCH = 2
DEC_SEQ = 1024
PAST_LEN = 256

GRID_W = 64
D_CONV = D_MODEL // 2
CONV_WIDTH = 31
HEAD_DIM = 64
N_HEADS_NA = D_MODEL // 128
D_NA = N_HEADS_NA * HEAD_DIM
WIN_H_MAX = 8
WIN_W = 16
QB_W = 16
KB_W = 2 * WIN_W
ROPE_BASE = 10000.0
Q_BLOCK = 128
D_GM = D_MODEL // 2
GM_CHUNK = 128
GM_GROUPS = 4
GM_CH = D_GM // GM_GROUPS
N_BRANCH = 3
D_IN = 2 * D_CONV + 3 * D_NA + 2 * D_GM + N_BRANCH * D_MODEL
N_EGROUPS = 4
EXP_PER_GROUP = 8
N_EXPERTS = N_EGROUPS * EXP_PER_GROUP
TOP_K = 2
D_EXPERT = D_MODEL // 8
ALPHA = (2 * DEPTH) ** 0.25
BETA = (8 * DEPTH) ** -0.25
LN_EPS = 1e-5
NEG_INF = -1e30

kernel_name = "hybrid_diffusion_conv_natten_gmlp_hmoe_step"


def layer_norm(x, g, b):
    xf = x.astype(jnp.float32)
    mu = jnp.mean(xf, axis=-1, keepdims=True)
    var = jnp.mean(jnp.square(xf - mu), axis=-1, keepdims=True)
    return ((xf - mu) * lax.rsqrt(var + LN_EPS)).astype(x.dtype) * g + b


def rope_axis(x, pos):
    n = x.shape[-1]
    inv = ROPE_BASE ** (-jnp.arange(0, n, 2, dtype=jnp.float32) / n)
    ang = pos[:, None] * inv[None, :]
    cos = jnp.cos(ang)[None, :, None, :]
    sin = jnp.sin(ang)[None, :, None, :]
    x1, x2 = x[..., : n // 2], x[..., n // 2:]
    return jnp.concatenate([x1 * cos - x2 * sin, x1 * sin + x2 * cos], axis=-1)


def axial_rope(x):
    L = x.shape[1]
    t = jnp.arange(L)
    pr = (t // GRID_W).astype(jnp.float32)
    pc = (t % GRID_W).astype(jnp.float32)
    half = HEAD_DIM // 2
    out = jnp.concatenate([rope_axis(x[..., :half], pr), rope_axis(x[..., half:], pc)], axis=-1)
    return out.astype(x.dtype)


def conformer_conv(a, b, conv_dw, conv_b, ln_g, ln_b, conv_pw):
    y = a * jax.nn.sigmoid(b)
    y = lax.conv_general_dilated(
        y, conv_dw[:, None, :], window_strides=(1,),
        padding=[(CONV_WIDTH // 2, CONV_WIDTH // 2)],
        dimension_numbers=("NWC", "WIO", "NWC"),
        feature_group_count=D_CONV) + conv_b
    y = jax.nn.silu(layer_norm(y, ln_g, ln_b))
    return y @ conv_pw


def spatial_gating(u, v, ln_g, ln_b, ws, bs, out):
    B, L, _ = u.shape
    n = L // GM_CHUNK
    u = jax.nn.gelu(u)
    v = layer_norm(jax.nn.gelu(v), ln_g, ln_b).reshape(B, n, GM_CHUNK, GM_GROUPS, GM_CH)
    sv = jnp.einsum('gpq,bnqgc->bnpgc', ws, v) + bs.T[:, :, None]
    return (u * sv.reshape(B, L, D_GM)) @ out


def context_attention(q, k, v):
    B, L, H, hd = q.shape
    nb = L // Q_BLOCK
    scale = hd ** -0.5
    qb = q.reshape(B, nb, Q_BLOCK, H, hd).transpose(1, 0, 2, 3, 4)

    def one_block(qi):
        s = jnp.einsum('bqhd,bkhd->bhqk', qi, k).astype(jnp.float32) * scale
        p = jax.nn.softmax(s, axis=-1).astype(v.dtype)
        return jnp.einsum('bhqk,bkhd->bqhd', p, v)

    o = lax.map(one_block, qb)
    return o.transpose(1, 0, 2, 3, 4).reshape(B, L, H * hd)


def neighbourhood_attention(q, k, v, ck, cv, rpb):
    B, L, H, hd = q.shape
    rows = L // GRID_W
    wh = min(WIN_H_MAX, rows)
    ncb = GRID_W // QB_W
    scale = hd ** -0.5
    kg = k.reshape(B, rows, GRID_W, H, hd)
    vg = v.reshape(B, rows, GRID_W, H, hd)
    qg = q.reshape(B, rows, ncb, QB_W, H, hd)
    r_all = jnp.arange(rows)
    row_start = jnp.clip(r_all - wh // 2, 0, rows - wh)
    row_idx = row_start[:, None] + jnp.arange(wh)
    j = jnp.arange(ncb)
    kb_start = jnp.clip(j * QB_W - WIN_W // 2, 0, GRID_W - KB_W)
    col_idx = kb_start[:, None] + jnp.arange(KB_W)
    qcol = j[:, None] * QB_W + jnp.arange(QB_W)
    col_start = jnp.clip(qcol - WIN_W // 2, 0, GRID_W - WIN_W)
    kc = col_idx[:, None, :]
    col_valid = (kc >= col_start[..., None]) & (kc < col_start[..., None] + WIN_W)
    col_mask = jnp.where(col_valid, 0.0, NEG_INF).astype(jnp.float32)
    dc_idx = jnp.clip(kc - qcol[..., None] + WIN_W - 1, 0, 2 * WIN_W - 2)
    n_loc = wh * KB_W

    def per_row(args):
        qr, ridx, r = args
        kr = kg[:, ridx][:, :, col_idx]
        vr = vg[:, ridx][:, :, col_idx]
        s_loc = jnp.einsum('bjqhd,bwjkhd->bhjqwk', qr, kr).astype(jnp.float32) * scale
        bias = rpb[:, ridx - r + WIN_H_MAX - 1][:, :, dc_idx]
        s_loc = s_loc + bias.transpose(0, 2, 3, 1, 4)[None] + col_mask[:, :, None, :]
        s_ctx = jnp.einsum('bjqhd,bchd->bhjqc', qr, ck).astype(jnp.float32) * scale
        s = jnp.concatenate([s_loc.reshape(B, H, ncb, QB_W, n_loc), s_ctx], axis=-1)
        p = jax.nn.softmax(s, axis=-1).astype(v.dtype)
        p_loc = p[..., :n_loc].reshape(B, H, ncb, QB_W, wh, KB_W)
        p_ctx = p[..., n_loc:]
        return (jnp.einsum('bhjqwk,bwjkhd->bjqhd', p_loc, vr)
                + jnp.einsum('bhjqc,bchd->bjqhd', p_ctx, cv))

    o = lax.map(per_row, (qg.transpose(1, 0, 2, 3, 4, 5), row_idx, r_all))
    return o.transpose(1, 0, 2, 3, 4, 5).reshape(B, L, H * hd)


def token_mixer(h, w_in, conv_dw, conv_b, conv_ln_g, conv_ln_b, conv_pw, na_rpb, na_out,
                gm_ln_g, gm_ln_b, gm_ws, gm_bs, gm_out, w_o, ctx_k, ctx_v):
    B, L, _ = h.shape
    z = h @ w_in
    cuts = [D_CONV, 2 * D_CONV, 2 * D_CONV + D_NA, 2 * D_CONV + 2 * D_NA,
            2 * D_CONV + 3 * D_NA, 2 * D_CONV + 3 * D_NA + D_GM,
            2 * D_CONV + 3 * D_NA + 2 * D_GM]
    ca, cb, q, k, v, gu, gv, gz = jnp.split(z, cuts, axis=-1)
    q = q.reshape(B, L, N_HEADS_NA, HEAD_DIM)
    k = k.reshape(B, L, N_HEADS_NA, HEAD_DIM)
    v = v.reshape(B, L, N_HEADS_NA, HEAD_DIM)
    br_conv = conformer_conv(ca, cb, conv_dw, conv_b, conv_ln_g, conv_ln_b, conv_pw)
    if ctx_k is None:
        att = context_attention(q, k, v)
    else:
        att = neighbourhood_attention(axial_rope(q), axial_rope(k), v, ctx_k, ctx_v, na_rpb)
    br_att = att @ na_out
    br_gm = spatial_gating(gu, gv, gm_ln_g, gm_ln_b, gm_ws, gm_bs, gm_out)
    g = jax.nn.sigmoid(gz).reshape(B, L, N_BRANCH, D_MODEL)
    merged = g[:, :, 0] * br_conv + g[:, :, 1] * br_att + g[:, :, 2] * br_gm
    return merged @ w_o, k, v


def hier_moe(h, rg_w, rg_b, re_w, re_b, w1, w3, w2):
    B, L, D = h.shape
    t = h.reshape(B * L, D)
    g_logits = (t @ rg_w + rg_b).astype(jnp.float32)
    g_prob = jax.nn.softmax(g_logits, axis=-1)
    g_idx = jnp.argmax(g_logits, axis=-1)
    g_p = jnp.take_along_axis(g_prob, g_idx[:, None], axis=-1)
    e_logits = (jnp.einsum('td,gde->tge', t, re_w) + re_b).astype(jnp.float32)
    e_sel = jnp.take_along_axis(e_logits, g_idx[:, None, None], axis=1)[:, 0]
    top_v, top_i = lax.top_k(e_sel, TOP_K)
    top_w = jax.nn.softmax(top_v, axis=-1) * g_p
    expert_id = g_idx[:, None] * EXP_PER_GROUP + top_i
    gate = jnp.sum(jax.nn.one_hot(expert_id, N_EXPERTS, dtype=jnp.float32) * top_w[..., None], axis=1)
    hid = jax.nn.silu(jnp.einsum('td,edf->tef', t, w1)) * jnp.einsum('td,edf->tef', t, w3)
    hid = hid * gate[..., None].astype(hid.dtype)
    return jnp.einsum('tef,efd->td', hid, w2).reshape(B, L, D)


def trunk_layer(x, cvec, w_ada, b_ada, mix_params, ln1_g, ln1_b, moe_params, ln2_g, ln2_b,
                ctx_k, ctx_v):
    m = (jax.nn.silu(cvec) @ w_ada + b_ada)[:, None, :]
    sh1, sc1, g1, sh2, sc2, g2 = jnp.split(m, 6, axis=-1)
    mix, k, v = token_mixer(x * (1 + sc1) + sh1, *mix_params, ctx_k, ctx_v)
    x = layer_norm(ALPHA * x + g1 * mix, ln1_g, ln1_b)
    y = hier_moe(x * (1 + sc2) + sh2, *moe_params)
    x = layer_norm(ALPHA * x + g2 * y, ln2_g, ln2_b)
    return x, k, v


def setup_inputs(seed: int = 0) -> dict:
    key = jax.random.key(seed)
    keys = jax.random.split(key, 48)
    counter = [0]

    def nrm(shape, s):
        kk = keys[counter[0]]
        counter[0] += 1
        return jax.random.normal(kk, shape, jnp.float32) * s

    L, D = DEPTH, D_MODEL
    return {
        "x_prompt": nrm((BATCH, SEQ, D), 1.0),
        "x_sample": nrm((DEC_BATCH, DEC_SEQ, D), 1.0),
        "cache_na_k": nrm((DEC_BATCH, DEPTH, PAST_LEN, N_HEADS_NA, HEAD_DIM), 1.0),
        "cache_na_v": nrm((DEC_BATCH, DEPTH, PAST_LEN, N_HEADS_NA, HEAD_DIM), 1.0),
        "c": nrm((DEC_BATCH, D), 1.0),
        "c_ctx": nrm((D,), 1.0),
        "w_ada": nrm((L, D, 6 * D), 0.2 * D ** -0.5),
        "b_ada": nrm((L, 6 * D), 0.01),
        "w_in": nrm((L, D, D_IN), D ** -0.5),
        "conv_dw": nrm((L, CONV_WIDTH, D_CONV), CONV_WIDTH ** -0.5),
        "conv_b": nrm((L, D_CONV), 0.01),
        "conv_ln_g": 1.0 + nrm((L, D_CONV), 0.02),
        "conv_ln_b": nrm((L, D_CONV), 0.01),
        "conv_pw": nrm((L, D_CONV, D), D_CONV ** -0.5),
        "na_rpb": nrm((L, N_HEADS_NA, 2 * WIN_H_MAX - 1, 2 * WIN_W - 1), 0.1),
        "na_out": nrm((L, D_NA, D), D_NA ** -0.5),
        "gm_ln_g": 1.0 + nrm((L, D_GM), 0.02),
        "gm_ln_b": nrm((L, D_GM), 0.01),
        "gm_ws": nrm((L, GM_GROUPS, GM_CHUNK, GM_CHUNK), GM_CHUNK ** -0.5),
        "gm_bs": 1.0 + nrm((L, GM_GROUPS, GM_CHUNK), 0.01),
        "gm_out": nrm((L, D_GM, D), D_GM ** -0.5),
        "w_o": nrm((L, D, D), BETA * D ** -0.5),
        "ln1_g": 1.0 + nrm((L, D), 0.02),
        "ln1_b": nrm((L, D), 0.01),
        "rg_w": nrm((L, D, N_EGROUPS), D ** -0.5),
        "rg_b": nrm((L, N_EGROUPS), 0.01),
        "re_w": nrm((L, N_EGROUPS, D, EXP_PER_GROUP), D ** -0.5),
        "re_b": nrm((L, N_EGROUPS, EXP_PER_GROUP), 0.01),
        "moe_w1": nrm((L, N_EXPERTS, D, D_EXPERT), D ** -0.5),
        "moe_w3": nrm((L, N_EXPERTS, D, D_EXPERT), D ** -0.5),
        "moe_w2": nrm((L, N_EXPERTS, D_EXPERT, D), BETA * D_EXPERT ** -0.5),
        "ln2_g": 1.0 + nrm((L, D), 0.02),
        "ln2_b": nrm((L, D), 0.01),
    }


def reference(x_prompt, x_sample, cache_na_k, cache_na_v, c, c_ctx, w_ada, b_ada, w_in,
              conv_dw, conv_b, conv_ln_g, conv_ln_b, conv_pw, na_rpb, na_out,
              gm_ln_g, gm_ln_b, gm_ws, gm_bs, gm_out, w_o, ln1_g, ln1_b,
              rg_w, rg_b, re_w, re_b, moe_w1, moe_w3, moe_w2, ln2_g, ln2_b):
    xp, xs = x_prompt, x_sample
    new_k, new_v = [], []
    for i in range(DEPTH):
        mix_params = (w_in[i], conv_dw[i], conv_b[i], conv_ln_g[i], conv_ln_b[i], conv_pw[i],
                      na_rpb[i], na_out[i], gm_ln_g[i], gm_ln_b[i], gm_ws[i], gm_bs[i],
                      gm_out[i], w_o[i])
        moe_params = (rg_w[i], rg_b[i], re_w[i], re_b[i], moe_w1[i], moe_w3[i], moe_w2[i])
        xp, kp, vp = trunk_layer(xp, c_ctx[None], w_ada[i], b_ada[i], mix_params,
                                 ln1_g[i], ln1_b[i], moe_params, ln2_g[i], ln2_b[i], None, None)
        new_k.append(kp)
        new_v.append(vp)
        xs, _, _ = trunk_layer(xs, c, w_ada[i], b_ada[i], mix_params,
                               ln1_g[i], ln1_b[i], moe_params, ln2_g[i], ln2_b[i],
                               cache_na_k[:, i], cache_na_v[:, i])
    new_na_k = jnp.stack(new_k, axis=1)
    new_na_v = jnp.stack(new_v, axis=1)
    return (xp, xs, new_na_k, new_na_v)
```

```cpp
#include <hip/hip_runtime.h>
#include <cstdio>
#include <cstdint>

#ifndef MK_MULTI
#define MK_MULTI 1
#endif

#define LAS __attribute__((address_space(3)))
#define GAS __attribute__((address_space(1)))
typedef unsigned short bf16_t;
typedef short bf16x8 __attribute__((ext_vector_type(8)));
typedef short s16x4 __attribute__((ext_vector_type(4)));
typedef float f32x4 __attribute__((ext_vector_type(4)));
typedef float f32x2 __attribute__((ext_vector_type(2)));
typedef unsigned u32x4 __attribute__((ext_vector_type(4)));
typedef unsigned u32x2 __attribute__((ext_vector_type(2)));
typedef __bf16 bf16x2_t __attribute__((ext_vector_type(2)));

constexpr int D = 1024, NT = 6144, NCTX = 4096, DIN = 6656, NLAYER = 4;
constexpr int NWAVES = 8, NTHREADS = 512, GRID = 256, NGW = GRID * NWAVES;
constexpr float ALPHA = 1.6817928305074290f;
constexpr float LN_EPS = 1e-5f;
constexpr size_t OUT_X = 0, OUT_K = (size_t)NT * D, OUT_V = OUT_K + (size_t)16 * 4 * 256 * 512;

constexpr size_t MiB = 1u << 20;
constexpr size_t OFF_CTL = 0;
constexpr size_t CTL_BYTES = 128 * 1024;
constexpr size_t OFF_ROPE = 1 * MiB;
constexpr size_t OFF_MOD = 1 * MiB + 64 * 1024;
constexpr size_t OFF_WINT = 2 * MiB;
constexpr size_t OFF_WPW = 54 * MiB;
constexpr size_t OFF_WO = 66 * MiB;
constexpr size_t OFF_W13 = 74 * MiB;
constexpr size_t OFF_W2 = 138 * MiB;
constexpr size_t OFF_WSB = 170 * MiB;
constexpr size_t OFF_CKB = 171 * MiB;
constexpr size_t OFF_CVB = 173 * MiB;
constexpr size_t OFF_H = 175 * MiB;
constexpr size_t OFF_ZC = 187 * MiB;
constexpr size_t OFF_QKV = 199 * MiB;
constexpr size_t OFF_GUV = 217 * MiB;
constexpr size_t OFF_GATES = 229 * MiB;
constexpr size_t OFF_AMIX = 265 * MiB;
constexpr size_t OFF_MERGED = 283 * MiB;
constexpr size_t OFF_Y = 295 * MiB;
constexpr size_t OFF_LIST = 319 * MiB;
constexpr size_t WS_END = 321 * MiB;
constexpr int CW_BAR = 0;
constexpr int CW_MOECNT = 16384;
constexpr int CW_ATTCTR = 16384 + 256;

constexpr int LDS_BYTES = 136 * 1024;

__device__ __forceinline__ unsigned cvtpk(float lo, float hi) { f32x2 v = {lo, hi}; bf16x2_t b = __builtin_convertvector(v, bf16x2_t); return __builtin_bit_cast(unsigned, b); }
__device__ __forceinline__ float bf2f(unsigned short h) { return __uint_as_float((unsigned)h << 16); }
__device__ __forceinline__ float bflo(unsigned w) { return __uint_as_float(w << 16); }
__device__ __forceinline__ float bfhi(unsigned w) { return __uint_as_float(w & 0xffff0000u); }
__device__ __forceinline__ float sigmoidf_(float x) { return 1.0f / (1.0f + __expf(-x)); }
__device__ __forceinline__ float siluf_(float x) { return x / (1.0f + __expf(-x)); }
__device__ __forceinline__ float geluf_(float x) { const float u = 0.7978845608028654f * (x + 0.044715f * x * x * x); return x / (1.0f + __expf(-2.0f * u)); }
__device__ __forceinline__ float wave_sum(float v) {
#pragma unroll
    for (int o = 1; o < 64; o <<= 1) v += __shfl_xor(v, o);
    return v;
}
#define VM_WAIT() asm volatile("s_waitcnt vmcnt(0)" ::: "memory")
#define LDS_WAIT() asm volatile("s_waitcnt lgkmcnt(0)" ::: "memory")
__device__ __forceinline__ void glds16(const void* g, LAS unsigned char* l) {
    __builtin_amdgcn_global_load_lds((const GAS unsigned*)g, (LAS unsigned*)l, 16, 0, 0);
}
__device__ __forceinline__ int otid() { int t = threadIdx.x; asm volatile("" : "+v"(t)); return t; }
__device__ __forceinline__ int obid() { int b = blockIdx.x; asm volatile("" : "+s"(b)); return b; }
__device__ __forceinline__ int mvec_of(int t) { return t < NCTX ? 0 : 1 + ((t - NCTX) >> 10); }

struct Params {
    const float* in[33];
    float* out;
    unsigned char* ws;
    int ph_lo, ph_hi;
};
enum { I_XP = 0, I_XS, I_CK, I_CV, I_C, I_CCTX, I_WADA, I_BADA, I_WIN, I_CONVDW, I_CONVB, I_CLNG, I_CLNB, I_CONVPW, I_RPB, I_NAOUT,
       I_GLNG, I_GLNB, I_GMWS, I_GMBS, I_GMOUT, I_WO, I_LN1G, I_LN1B, I_RGW, I_RGB, I_REW, I_REB, I_W1, I_W3, I_W2, I_LN2G, I_LN2B };

#define XB_TMO      128
#define XB_XCNT(j)  (256  + 64 * (j))
#define XB_XSUB(j)  (1280 + 64 * (j))
#define XB_XGEN(j)  (2304 + 64 * (j))
#define XB_TOP      3328
#define XB_TOPGEN   3392
#define XB_SPIN_CAP (1u << 20)
__device__ __forceinline__ unsigned xb_ld(unsigned* p)              { return __hip_atomic_load(p, __ATOMIC_RELAXED, __HIP_MEMORY_SCOPE_AGENT); }
__device__ __forceinline__ unsigned xb_add(unsigned* p, unsigned v) { return __hip_atomic_fetch_add(p, v, __ATOMIC_RELAXED, __HIP_MEMORY_SCOPE_AGENT); }
__device__ __forceinline__ unsigned xb_xcc_id() { return (unsigned)__builtin_amdgcn_s_getreg((3 << 11) | 20) & 0xFu; }
#define XB_SPIN(cond, bar) do { unsigned _sp = 0; while (cond) { __builtin_amdgcn_s_sleep(1); \
    if ((++_sp & 255u) == 0u) { if (xb_ld(&(bar)[XB_TMO])) break; if (_sp > XB_SPIN_CAP) { atomicAdd(&(bar)[XB_TMO], 1u); break; } } } } while (0)
struct XcdBarrier { unsigned* bar; unsigned x; volatile LAS unsigned* st; };
__device__ __forceinline__ XcdBarrier xcd_barrier_post(unsigned* bar, volatile LAS unsigned* st) {
    XcdBarrier b; b.bar = bar; b.x = xb_xcc_id(); b.st = st;
    if (threadIdx.x == 0) (void)xb_add(&bar[XB_XCNT(b.x)], 1u);
    return b;
}
__device__ __forceinline__ void xcd_barrier_complete(unsigned* bar, unsigned x, unsigned& nloc, unsigned& nx) {
    const unsigned G = gridDim.x * gridDim.y * gridDim.z;
    unsigned sum, cnt, mine, sp = 0u;
    for (;;) {
        sum = 0u; cnt = 0u; mine = 0u;
#pragma unroll
        for (unsigned j = 0; j < 16; ++j) { const unsigned c = xb_ld(&bar[XB_XCNT(j)]); sum += c; cnt += (c > 0u) ? 1u : 0u; mine = (j == x) ? c : mine; }
        if (sum == G) break;
        __builtin_amdgcn_s_sleep(1);
        if ((++sp & 255u) == 0u) { if (xb_ld(&bar[XB_TMO])) break; if (sp > XB_SPIN_CAP) { atomicAdd(&bar[XB_TMO], 1u); break; } }
    }
    nloc = mine > 0u ? mine : 1u; nx = cnt > 0u ? cnt : 1u;
}
__device__ __forceinline__ void xcd_barrier(const XcdBarrier& b) {
    asm volatile("s_waitcnt vmcnt(0)" ::: "memory");
    __syncthreads();
    if (threadIdx.x == 0) {
        unsigned* bar = b.bar;
        __builtin_amdgcn_s_waitcnt(0);
        unsigned nloc = b.st[0], nx = b.st[1];
        if (nloc == 0u) { xcd_barrier_complete(bar, b.x, nloc, nx); b.st[0] = nloc; b.st[1] = nx; }
        const unsigned old = xb_add(&bar[XB_XSUB(b.x)], 1u);
        const unsigned gen = old / nloc;
        if (old + 1u == (gen + 1u) * nloc) {
            __builtin_amdgcn_fence(__ATOMIC_RELEASE, "agent");
            asm volatile("s_waitcnt vmcnt(0)" ::: "memory");
            const unsigned og = xb_add(&bar[XB_TOP], 1u);
            const unsigned tg = og / nx;
            if (og + 1u == (tg + 1u) * nx) xb_add(&bar[XB_TOPGEN], 1u);
            else XB_SPIN(xb_ld(&bar[XB_TOPGEN]) == tg, bar);
            __builtin_amdgcn_fence(__ATOMIC_ACQUIRE, "agent");
            xb_add(&bar[XB_XGEN(b.x)], 1u);
            asm volatile("s_waitcnt vmcnt(0)" ::: "memory");
        } else {
            XB_SPIN(xb_ld(&bar[XB_XGEN(b.x)]) == gen, bar);
            __builtin_amdgcn_fence(__ATOMIC_ACQUIRE, "agent");
            asm volatile("s_waitcnt vmcnt(0)" ::: "memory");
        }
    }
    __syncthreads();
}

template <int MT, class AP, class BP>
__device__ __forceinline__ void gemm_loop(f32x4 (&acc)[MT][4], LAS unsigned char* lds, AP aptr, BP bptr, int nk, int tid) {
    constexpr int BM = 64 * MT, A_BYTES = BM * 128, STAGE = A_BYTES + 128 * 128, NAW = BM / 64;
    const int wid = tid >> 6, lane = tid & 63, fr = lane & 15, fq = lane >> 4;
    const int wm = wid >> 1, wn = wid & 1;
    const int rr = lane >> 3, lc = (lane & 7) ^ rr;
    const bf16_t* ap[NAW]; const bf16_t* bp[2];
#pragma unroll
    for (int i = 0; i < NAW; ++i) ap[i] = aptr((wid + 8 * i) * 8 + rr) + lc * 8;
#pragma unroll
    for (int i = 0; i < 2; ++i) bp[i] = bptr((wid + 8 * i) * 8 + rr) + lc * 8;
    __syncthreads();
#define GL_STAGE(kt, buf) do { LAS unsigned char* sa_ = lds + (buf) * STAGE; LAS unsigned char* sb_ = sa_ + A_BYTES; \
        _Pragma("unroll") for (int i = 0; i < NAW; ++i) glds16(ap[i] + (kt) * 64, sa_ + (wid + 8 * i) * 1024); \
        _Pragma("unroll") for (int i = 0; i < 2; ++i) glds16(bp[i] + (kt) * 64, sb_ + (wid + 8 * i) * 1024); } while (0)
    GL_STAGE(0, 0);
    for (int kt = 0; kt < nk; ++kt) {
        VM_WAIT(); __syncthreads();
        if (kt + 1 < nk) GL_STAGE(kt + 1, (kt + 1) & 1);
        LAS unsigned char* sa = lds + (kt & 1) * STAGE; LAS unsigned char* sb = sa + A_BYTES;
#pragma unroll
        for (int ks = 0; ks < 2; ++ks) {
            const int sw = ((ks * 4 + fq) ^ (fr & 7)) * 16;
            bf16x8 a[MT], b[4];
#pragma unroll
            for (int mt = 0; mt < MT; ++mt) a[mt] = *(const LAS bf16x8*)(sa + (wm * MT * 16 + mt * 16 + fr) * 128 + sw);
#pragma unroll
            for (int nt = 0; nt < 4; ++nt) b[nt] = *(const LAS bf16x8*)(sb + (wn * 64 + nt * 16 + fr) * 128 + sw);
#pragma unroll
            for (int mt = 0; mt < MT; ++mt)
#pragma unroll
                for (int nt = 0; nt < 4; ++nt) acc[mt][nt] = __builtin_amdgcn_mfma_f32_16x16x32_bf16(b[nt], a[mt], acc[mt][nt], 0, 0, 0);
        }
    }
#undef GL_STAGE
}
template <int MT> __device__ __forceinline__ void zero_acc(f32x4 (&acc)[MT][4]) {
#pragma unroll
    for (int mt = 0; mt < MT; ++mt)
#pragma unroll
        for (int nt = 0; nt < 4; ++nt) acc[mt][nt] = (f32x4){0.f, 0.f, 0.f, 0.f};
}

__device__ const float ROPE_INV[16] = {1.000000000e+00f, 5.623413324e-01f, 3.162277639e-01f, 1.778279394e-01f, 1.000000015e-01f, 5.623413250e-02f, 3.162277490e-02f, 1.778279431e-02f,
                                        9.999999776e-03f, 5.623413250e-03f, 3.162277630e-03f, 1.778279431e-03f, 1.000000047e-03f, 5.623413017e-04f, 3.162277571e-04f, 1.778279402e-04f};
__device__ __forceinline__ void sincos_small(double a, float& c, float& s) {
    const double q = __builtin_rint(a * 0.63661977236758134308);
    const double r = (a - q * 1.57079632679489655800) - q * 6.123233995736766e-17;
    const double r2 = r * r;
    double sp = r * (1.0 + r2 * (-1.0 / 6 + r2 * (1.0 / 120 + r2 * (-1.0 / 5040 + r2 * (1.0 / 362880 + r2 * (-1.0 / 39916800 + r2 * (1.0 / 6227020800.0)))))));
    double cp = 1.0 + r2 * (-0.5 + r2 * (1.0 / 24 + r2 * (-1.0 / 720 + r2 * (1.0 / 40320 + r2 * (-1.0 / 3628800 + r2 * (1.0 / 479001600.0 + r2 * (-1.0 / 87178291200.0)))))));
    const int qi = ((int)q) & 3;
    double cc = (qi == 0) ? cp : (qi == 1) ? -sp : (qi == 2) ? -cp : sp;
    double ss = (qi == 0) ? sp : (qi == 1) ? cp : (qi == 2) ? -sp : -cp;
    c = (float)cc; s = (float)ss;
}
__device__ __forceinline__ void transpose_item(const float* W, int K, int N, bf16_t* WT, LAS float* scr, int item, int lane) {
    const int nblk = N / 32, kb = item / nblk, nb = item % nblk, k0 = 64 * kb, n0 = 32 * nb;
#pragma unroll 8
    for (int i = 0; i < 32; ++i) { const int kk = 2 * i + (lane >> 5); scr[kk * 33 + (lane & 31)] = W[(size_t)(k0 + kk) * N + n0 + (lane & 31)]; }
    LDS_WAIT();
    const int c = lane & 7;
#pragma unroll
    for (int j = 0; j < 4; ++j) { const int n = (lane >> 3) + 8 * j; const LAS float* s = scr + (8 * c) * 33 + n;
        u32x4 o; o.x = cvtpk(s[0 * 33], s[1 * 33]); o.y = cvtpk(s[2 * 33], s[3 * 33]); o.z = cvtpk(s[4 * 33], s[5 * 33]); o.w = cvtpk(s[6 * 33], s[7 * 33]);
        *(u32x4*)(WT + (size_t)(n0 + n) * K + k0 + 8 * c) = o; }
    LDS_WAIT();
}
__device__ __forceinline__ void phase_prologue(const Params& P, LAS unsigned char* lds) {
    const int tid = otid(), wid = tid >> 6, lane = tid & 63, bid = obid();
    const int gw = bid * NWAVES + wid;
    unsigned char* ws = P.ws;
    if (bid == 1) {
        for (int e = tid; e < 64 * 16; e += NTHREADS) { const int pos = e >> 4, j = e & 15; const float ang = (float)pos * ROPE_INV[j]; float c, s; sincos_small((double)ang, c, s);
            ((f32x2*)(ws + OFF_ROPE))[e] = (f32x2){c, s}; }
    }
    {
        const int gt = bid * NTHREADS + tid, NGT = GRID * NTHREADS;
        for (int e = gt; e < 131072; e += NGT) {
            const f32x4 a0 = ((const f32x4*)P.in[I_CK])[2 * e], a1 = ((const f32x4*)P.in[I_CK])[2 * e + 1];
            ((u32x4*)(ws + OFF_CKB))[e] = (u32x4){cvtpk(a0.x, a0.y), cvtpk(a0.z, a0.w), cvtpk(a1.x, a1.y), cvtpk(a1.z, a1.w)};
            const f32x4 b0 = ((const f32x4*)P.in[I_CV])[2 * e], b1 = ((const f32x4*)P.in[I_CV])[2 * e + 1];
            ((u32x4*)(ws + OFF_CVB))[e] = (u32x4){cvtpk(b0.x, b0.y), cvtpk(b0.z, b0.w), cvtpk(b1.x, b1.y), cvtpk(b1.z, b1.w)};
        }
        for (int e = gt; e < 32768; e += NGT) {
            const f32x4 a0 = ((const f32x4*)P.in[I_GMWS])[2 * e], a1 = ((const f32x4*)P.in[I_GMWS])[2 * e + 1];
            ((u32x4*)(ws + OFF_WSB))[e] = (u32x4){cvtpk(a0.x, a0.y), cvtpk(a0.z, a0.w), cvtpk(a1.x, a1.y), cvtpk(a1.z, a1.w)};
        }
    }
    {
        LAS float* sv = (LAS float*)lds;
        LAS float* red = (LAS float*)(lds + 12288);
        for (int e = tid; e < 3 * D; e += NTHREADS) { const int v = e >> 10, k = e & 1023; const float x = (v == 0) ? P.in[I_CCTX][k] : P.in[I_C][(v - 1) * D + k]; sv[e] = siluf_(x); }
        __syncthreads();
        const int kq = tid >> 4, c4 = tid & 15;
        for (int item = bid; item < NLAYER * 96; item += GRID) {
            const int l = item / 96, n0 = (item % 96) * 64;
            const float* W = P.in[I_WADA] + (size_t)l * D * 6144 + n0 + 4 * c4;
            f32x4 a0 = {0, 0, 0, 0}, a1 = a0, a2 = a0;
#pragma unroll 4
            for (int i = 0; i < 32; ++i) { const int k = kq + 32 * i; const f32x4 w = *(const f32x4*)(W + (size_t)k * 6144);
                a0 += w * sv[k]; a1 += w * sv[D + k]; a2 += w * sv[2 * D + k]; }
            LAS float* r = red + kq * 192 + 4 * c4;
            *(LAS f32x4*)(r) = a0; *(LAS f32x4*)(r + 64) = a1; *(LAS f32x4*)(r + 128) = a2;
            __syncthreads();
            if (tid < 192) { float s = 0.f;
#pragma unroll 8
                for (int q = 0; q < 32; ++q) s += red[q * 192 + tid];
                const int v = tid >> 6, n = n0 + (tid & 63);
                ((float*)(ws + OFF_MOD))[((size_t)l * 3 + v) * 6144 + n] = s + P.in[I_BADA][l * 6144 + n]; }
            __syncthreads();
        }
    }
    {
        LAS float* scr = (LAS float*)(lds + wid * 16384);
        constexpr int I_IN = (1024 / 64) * (DIN / 32);
        constexpr int I_PW = (512 / 64) * (1024 / 32);
        constexpr int I_O = (1024 / 64) * (1024 / 32);
        constexpr int I_13 = (1024 / 64) * (128 / 32);
        constexpr int I_2 = (128 / 64) * (1024 / 32);
        constexpr int PER_LAYER = I_IN + 3 * I_PW + I_O + 32 * 2 * I_13 + 32 * I_2;
        for (int it = gw; it < NLAYER * PER_LAYER; it += NGW) {
            const int l = it / PER_LAYER; int r = it % PER_LAYER;
            if (r < I_IN) { transpose_item(P.in[I_WIN] + (size_t)l * D * DIN, D, DIN, (bf16_t*)(ws + OFF_WINT) + (size_t)l * DIN * D, scr, r, lane); continue; } r -= I_IN;
            if (r < 3 * I_PW) { const int b = r / I_PW; r %= I_PW; const float* src = (b == 0 ? P.in[I_CONVPW] : b == 1 ? P.in[I_NAOUT] : P.in[I_GMOUT]) + (size_t)l * 512 * D;
                transpose_item(src, 512, D, (bf16_t*)(ws + OFF_WPW) + ((size_t)l * 3 + b) * D * 512, scr, r, lane); continue; } r -= 3 * I_PW;
            if (r < I_O) { transpose_item(P.in[I_WO] + (size_t)l * D * D, D, D, (bf16_t*)(ws + OFF_WO) + (size_t)l * D * D, scr, r, lane); continue; } r -= I_O;
            if (r < 64 * I_13) { const int e = r / (2 * I_13), w = (r / I_13) & 1; r %= I_13; const float* src = (w == 0 ? P.in[I_W1] : P.in[I_W3]) + ((size_t)l * 32 + e) * D * 128;
                transpose_item(src, D, 128, (bf16_t*)(ws + OFF_W13) + (((size_t)l * 32 + e) * 256 + w * 128) * D, scr, r, lane); continue; } r -= 64 * I_13;
            { const int e = r / I_2; r %= I_2; transpose_item(P.in[I_W2] + ((size_t)l * 32 + e) * 128 * D, 128, D, (bf16_t*)(ws + OFF_W2) + ((size_t)l * 32 + e) * D * 128, scr, r, lane); }
        }
    }
}

__device__ __forceinline__ void phase_rows_final(const Params& P, int layer) {
    const int tid = otid(), wid = tid >> 6, lane = tid & 63;
    const int gw = obid() * NWAVES + wid;
    float* X = P.out;
    const bf16_t* Y = (const bf16_t*)(P.ws + OFF_Y);
    bf16_t* H = (bf16_t*)(P.ws + OFF_H);
    const float* MOD = (const float*)(P.ws + OFF_MOD);
    for (int t = gw; t < NT; t += NGW) {
        const int mv = mvec_of(t);
        f32x4 v[4];
        if (layer == 0) {
            const float* src = (t < NCTX) ? P.in[I_XP] + (size_t)t * D : P.in[I_XS] + (size_t)(t - NCTX) * D;
#pragma unroll
            for (int j = 0; j < 4; ++j) v[j] = *(const f32x4*)(src + 4 * lane + 256 * j);
        } else {
            const float* g2 = MOD + ((size_t)(layer - 1) * 3 + mv) * 6144 + 5 * D;
            const float* lg = P.in[I_LN2G] + (layer - 1) * D; const float* lb = P.in[I_LN2B] + (layer - 1) * D;
            float s = 0.f;
#pragma unroll
            for (int j = 0; j < 4; ++j) { const int c = 4 * lane + 256 * j;
                const f32x4 x = *(const f32x4*)(X + (size_t)t * D + c); const f32x4 g = *(const f32x4*)(g2 + c);
                const u32x2 y0 = *(const u32x2*)(Y + (size_t)t * D + c), y1 = *(const u32x2*)(Y + ((size_t)NT + t) * D + c);
                f32x4 y = {bflo(y0.x) + bflo(y1.x), bfhi(y0.x) + bfhi(y1.x), bflo(y0.y) + bflo(y1.y), bfhi(y0.y) + bfhi(y1.y)};
                v[j] = x * ALPHA + g * y; s += (v[j].x + v[j].y) + (v[j].z + v[j].w); }
            const float mean = wave_sum(s) * (1.f / D); float q = 0.f;
#pragma unroll
            for (int j = 0; j < 4; ++j) { v[j] = v[j] - mean; q += (v[j].x * v[j].x + v[j].y * v[j].y) + (v[j].z * v[j].z + v[j].w * v[j].w); }
            const float rstd = rsqrtf(wave_sum(q) * (1.f / D) + LN_EPS);
#pragma unroll
            for (int j = 0; j < 4; ++j) { const int c = 4 * lane + 256 * j; v[j] = v[j] * rstd * *(const f32x4*)(lg + c) + *(const f32x4*)(lb + c); }
        }
#pragma unroll
        for (int j = 0; j < 4; ++j) *(f32x4*)(X + (size_t)t * D + 4 * lane + 256 * j) = v[j];
        if (layer < NLAYER) {
            const float* sh = MOD + ((size_t)layer * 3 + mv) * 6144; const float* sc = sh + D;
#pragma unroll
            for (int j = 0; j < 4; ++j) { const int c = 4 * lane + 256 * j; const f32x4 h = v[j] * (*(const f32x4*)(sc + c) + 1.0f) + *(const f32x4*)(sh + c);
                *(u32x2*)(H + (size_t)t * D + c) = (u32x2){cvtpk(h.x, h.y), cvtpk(h.z, h.w)}; }
        }
    }
}

__device__ __forceinline__ void phase_win(const Params& P, int layer, LAS unsigned char* lds) {
    const int tid = otid(), wid = tid >> 6, lane = tid & 63, fr = lane & 15, fq = lane >> 4, wm = wid >> 1, wn = wid & 1;
    unsigned char* ws = P.ws;
    const bf16_t* H = (const bf16_t*)(ws + OFF_H);
    const bf16_t* WT = (const bf16_t*)(ws + OFF_WINT) + (size_t)layer * DIN * D;
    bf16_t* ZC = (bf16_t*)(ws + OFF_ZC); bf16_t* QKV = (bf16_t*)(ws + OFF_QKV); bf16_t* GUV = (bf16_t*)(ws + OFF_GUV); bf16_t* GATES = (bf16_t*)(ws + OFF_GATES);
    const f32x4* ROPE = (const f32x4*)(ws + OFF_ROPE);
    constexpr int NTN = DIN / 128, NTILES = (NT / 256) * NTN;
    for (int T = obid(); T < NTILES; T += GRID) {
        const int pm = T / NTN, pn = T % NTN, m0 = pm * 256, n0 = pn * 128;
        f32x4 acc[4][4]; zero_acc<4>(acc);
        gemm_loop<4>(acc, lds, [&](int r) { return H + (size_t)(m0 + r) * D; }, [&](int n) { return WT + (size_t)(n0 + n) * D; }, D / 64, tid);
        const int nw = n0 + wn * 64;
        const int rw = m0 + wm * 64;
        if (n0 < 1024) {
#pragma unroll
            for (int mt = 0; mt < 4; ++mt) { bf16_t* o = ZC + (size_t)(rw + mt * 16 + fr) * 1024 + nw + 4 * fq;
#pragma unroll
                for (int nt = 0; nt < 4; ++nt) *(u32x2*)(o + nt * 16) = (u32x2){cvtpk(acc[mt][nt].x, acc[mt][nt].y), cvtpk(acc[mt][nt].z, acc[mt][nt].w)}; }
        } else if (n0 < 2560) {
            const int cw = nw - 1024, which = cw >> 9;
            const bool latent = (m0 >= NCTX);
            if (latent && which < 2) {
#pragma unroll
                for (int mt = 0; mt < 4; ++mt) { const int l = (rw + mt * 16 + fr - NCTX) & 1023, pr = l >> 6, pc = l & 63;
                    const f32x4 r0 = ROPE[pr * 8 + 2 * fq], r1 = ROPE[pr * 8 + 2 * fq + 1], c0 = ROPE[pc * 8 + 2 * fq], c1 = ROPE[pc * 8 + 2 * fq + 1];
                    const float cr[4] = {r0.x, r0.z, r1.x, r1.z}, sr[4] = {r0.y, r0.w, r1.y, r1.w}, cc[4] = {c0.x, c0.z, c1.x, c1.z}, sc[4] = {c0.y, c0.w, c1.y, c1.w};
#pragma unroll
                    for (int e = 0; e < 4; ++e) { const float x1 = acc[mt][0][e], x2 = acc[mt][1][e]; acc[mt][0][e] = x1 * cr[e] - x2 * sr[e]; acc[mt][1][e] = x1 * sr[e] + x2 * cr[e];
                        const float y1 = acc[mt][2][e], y2 = acc[mt][3][e]; acc[mt][2][e] = y1 * cc[e] - y2 * sc[e]; acc[mt][3][e] = y1 * sc[e] + y2 * cc[e]; } }
            }
            if (!latent && which >= 1) {
                float* ob = P.out + (which == 1 ? OUT_K : OUT_V);
#pragma unroll
                for (int mt = 0; mt < 4; ++mt) { const int t = rw + mt * 16 + fr, b = t >> 8, l = t & 255; float* o = ob + (((size_t)b * 4 + layer) * 256 + l) * 512 + (cw - 512 * which) + 4 * fq;
#pragma unroll
                    for (int nt = 0; nt < 4; ++nt) *(f32x4*)(o + nt * 16) = acc[mt][nt]; }
            }
            const float qs = (which == 0) ? 0.125f : 1.0f;
#pragma unroll
            for (int mt = 0; mt < 4; ++mt) { bf16_t* o = QKV + (size_t)(rw + mt * 16 + fr) * 1536 + cw + 4 * fq;
#pragma unroll
                for (int nt = 0; nt < 4; ++nt) { const f32x4 a = acc[mt][nt] * qs; *(u32x2*)(o + nt * 16) = (u32x2){cvtpk(a.x, a.y), cvtpk(a.z, a.w)}; } }
        } else if (n0 < 3584) {
#pragma unroll
            for (int mt = 0; mt < 4; ++mt) { bf16_t* o = GUV + (size_t)(rw + mt * 16 + fr) * 1024 + (nw - 2560) + 4 * fq;
#pragma unroll
                for (int nt = 0; nt < 4; ++nt) { const f32x4 a = acc[mt][nt]; *(u32x2*)(o + nt * 16) = (u32x2){cvtpk(geluf_(a.x), geluf_(a.y)), cvtpk(geluf_(a.z), geluf_(a.w))}; } }
        } else {
#pragma unroll
            for (int mt = 0; mt < 4; ++mt) { bf16_t* o = GATES + (size_t)(rw + mt * 16 + fr) * 3072 + (nw - 3584) + 4 * fq;
#pragma unroll
                for (int nt = 0; nt < 4; ++nt) { const f32x4 a = acc[mt][nt]; *(u32x2*)(o + nt * 16) = (u32x2){cvtpk(sigmoidf_(a.x), sigmoidf_(a.y)), cvtpk(sigmoidf_(a.z), sigmoidf_(a.w))}; } }
        }
    }
}

__device__ __forceinline__ void conv_item(const Params& P, int layer, int item, LAS unsigned char* lds) {
    const int tid = otid(), wid = tid >> 6, lane = tid & 63;
    const bf16_t* ZC = (const bf16_t*)(P.ws + OFF_ZC);
    bf16_t* AO = (bf16_t*)(P.ws + OFF_AMIX);
    LAS unsigned* tin = (LAS unsigned*)lds;
    LAS float* yb = (LAS float*)(lds + 46 * 1024);
    const int t0 = item * 16;
    int s0, s1; if (t0 < NCTX) { s0 = t0 & ~255; s1 = s0 + 256; } else { s0 = NCTX + ((t0 - NCTX) & ~1023); s1 = s0 + 1024; }
    const int c2 = tid & 255, rh = tid >> 8;
    for (int r = rh; r < 46; r += 2) { const int t = t0 - 15 + r; unsigned o = 0u;
        if (t >= s0 && t < s1) { const unsigned a = *(const unsigned*)(ZC + (size_t)t * 1024 + 2 * c2), b = *(const unsigned*)(ZC + (size_t)t * 1024 + 512 + 2 * c2);
            o = cvtpk(bflo(a) * sigmoidf_(bflo(b)), bfhi(a) * sigmoidf_(bfhi(b))); }
        tin[r * 256 + c2] = o; }
    const float* dw = P.in[I_CONVDW] + (size_t)layer * 31 * 512 + 2 * c2;
    const f32x2 cb = *(const f32x2*)(P.in[I_CONVB] + layer * 512 + 2 * c2);
    f32x2 acc[8];
#pragma unroll
    for (int p = 0; p < 8; ++p) acc[p] = cb;
    __syncthreads();
#pragma unroll
    for (int w = 0; w < 31; ++w) { const f32x2 k = *(const f32x2*)(dw + w * 512);
#pragma unroll
        for (int p = 0; p < 8; ++p) { const unsigned x = tin[(rh * 8 + p + w) * 256 + c2]; acc[p].x += k.x * bflo(x); acc[p].y += k.y * bfhi(x); } }
#pragma unroll
    for (int p = 0; p < 8; ++p) *(LAS f32x2*)(yb + (rh * 8 + p) * 512 + 2 * c2) = acc[p];
    __syncthreads();
    const float* lg = P.in[I_CLNG] + layer * 512 + 8 * lane; const float* lb = P.in[I_CLNB] + layer * 512 + 8 * lane;
#pragma unroll
    for (int rr = 0; rr < 2; ++rr) { const int r = wid * 2 + rr;
        f32x4 a = *(const LAS f32x4*)(yb + r * 512 + 8 * lane), b = *(const LAS f32x4*)(yb + r * 512 + 8 * lane + 4);
        const float mean = wave_sum((a.x + a.y) + (a.z + a.w) + (b.x + b.y) + (b.z + b.w)) * (1.f / 512);
        a = a - mean; b = b - mean;
        const float rstd = rsqrtf(wave_sum((a.x * a.x + a.y * a.y) + (a.z * a.z + a.w * a.w) + (b.x * b.x + b.y * b.y) + (b.z * b.z + b.w * b.w)) * (1.f / 512) + LN_EPS);
        a = a * rstd * *(const f32x4*)(lg) + *(const f32x4*)(lb); b = b * rstd * *(const f32x4*)(lg + 4) + *(const f32x4*)(lb + 4);
        *(u32x4*)(AO + (size_t)(t0 + r) * 512 + 8 * lane) = (u32x4){cvtpk(siluf_(a.x), siluf_(a.y)), cvtpk(siluf_(a.z), siluf_(a.w)), cvtpk(siluf_(b.x), siluf_(b.y)), cvtpk(siluf_(b.z), siluf_(b.w))}; }
    __syncthreads();
}

__device__ __forceinline__ void gating_item(const Params& P, int layer, int item, LAS unsigned char* lds) {
    const int tid = otid(), wid = tid >> 6, lane = tid & 63, fr = lane & 15, fq = lane >> 4;
    const int ch = item >> 2, g = item & 3, t0 = ch * 128;
    const bf16_t* GUV = (const bf16_t*)(P.ws + OFF_GUV);
    bf16_t* AO = (bf16_t*)(P.ws + OFF_AMIX) + (size_t)2 * NT * 512;
    const float* lg = P.in[I_GLNG] + layer * 512 + 8 * lane; const float* lb = P.in[I_GLNB] + layer * 512 + 8 * lane;
    for (int rr = 0; rr < 16; ++rr) { const int q = wid * 16 + rr;
        const u32x4 w = *(const u32x4*)(GUV + (size_t)(t0 + q) * 1024 + 512 + 8 * lane);
        float x[8] = {bflo(w.x), bfhi(w.x), bflo(w.y), bfhi(w.y), bflo(w.z), bfhi(w.z), bflo(w.w), bfhi(w.w)};
        float s = 0.f;
#pragma unroll
        for (int e = 0; e < 8; ++e) s += x[e];
        const float mean = wave_sum(s) * (1.f / 512); float qq = 0.f;
#pragma unroll
        for (int e = 0; e < 8; ++e) { x[e] -= mean; qq += x[e] * x[e]; }
        const float rstd = rsqrtf(wave_sum(qq) * (1.f / 512) + LN_EPS);
        if ((lane >> 4) == g) { const f32x4 g0 = *(const f32x4*)lg, g1 = *(const f32x4*)(lg + 4), b0 = *(const f32x4*)lb, b1 = *(const f32x4*)(lb + 4);
            const u32x4 o = {cvtpk(x[0] * rstd * g0.x + b0.x, x[1] * rstd * g0.y + b0.y), cvtpk(x[2] * rstd * g0.z + b0.z, x[3] * rstd * g0.w + b0.w),
                             cvtpk(x[4] * rstd * g1.x + b1.x, x[5] * rstd * g1.y + b1.y), cvtpk(x[6] * rstd * g1.z + b1.z, x[7] * rstd * g1.w + b1.w)};
            const int li = lane & 15;
            *(LAS u32x4*)(lds + q * 256 + ((((li >> 1) ^ (q & 7)) << 5) | ((li & 1) << 4))) = o; }
    }
    __syncthreads();
    const bf16_t* WS = (const bf16_t*)(P.ws + OFF_WSB) + (((size_t)layer * 4 + g) * 128 + wid * 16 + fr) * 128;
    f32x4 acc[8];
#pragma unroll
    for (int ct = 0; ct < 8; ++ct) acc[ct] = (f32x4){0.f, 0.f, 0.f, 0.f};
#pragma unroll
    for (int ks = 0; ks < 4; ++ks) {
        const s16x4 y0 = *(const s16x4*)(WS + 32 * ks + 4 * fq), y1 = *(const s16x4*)(WS + 32 * ks + 16 + 4 * fq);
        const bf16x8 yf = {y0[0], y0[1], y0[2], y0[3], y1[0], y1[1], y1[2], y1[3]};
        const int qa = 32 * ks + 4 * fq + (fr >> 2), qb = qa + 16;
#pragma unroll
        for (int ct = 0; ct < 8; ++ct) {
            const s16x4 x0 = __builtin_amdgcn_ds_read_tr16_b64_v4i16((LAS s16x4*)(lds + qa * 256 + (((ct ^ (qa & 7)) << 5) | ((fr & 3) << 3))));
            const s16x4 x1 = __builtin_amdgcn_ds_read_tr16_b64_v4i16((LAS s16x4*)(lds + qb * 256 + (((ct ^ (qb & 7)) << 5) | ((fr & 3) << 3))));
            const bf16x8 xf = {x0[0], x0[1], x0[2], x0[3], x1[0], x1[1], x1[2], x1[3]};
            acc[ct] = __builtin_amdgcn_mfma_f32_16x16x32_bf16(xf, yf, acc[ct], 0, 0, 0);
        }
    }
    const int p = wid * 16 + fr; const float bs = P.in[I_GMBS][(layer * 4 + g) * 128 + p];
#pragma unroll
    for (int ct = 0; ct < 8; ++ct) { const int c = g * 128 + ct * 16 + 4 * fq;
        const u32x2 u = *(const u32x2*)(GUV + (size_t)(t0 + p) * 1024 + c);
        const f32x4 sv = acc[ct] + bs;
        *(u32x2*)(AO + (size_t)(t0 + p) * 512 + c) = (u32x2){cvtpk(bflo(u.x) * sv.x, bfhi(u.x) * sv.y), cvtpk(bflo(u.y) * sv.z, bfhi(u.y) * sv.w)}; }
    __syncthreads();
}

__device__ __forceinline__ void attn_item(const Params& P, int layer, int item, LAS unsigned char* wl, int lane) {
    const int fr = lane & 15, fq = lane >> 4;
    const bf16_t* QKV = (const bf16_t*)(P.ws + OFF_QKV);
    bf16_t* AO = (bf16_t*)(P.ws + OFF_AMIX) + (size_t)NT * 512;
    const bool latent = item < 1024;
    int b, h, j = 0, r = 0, qtok0;
    if (latent) { j = item & 3; r = (item >> 2) & 15; h = (item >> 6) & 7; b = item >> 9; qtok0 = NCTX + b * 1024 + r * 64 + j * 16; }
    else { const int it = item - 1024; const int qb = it & 15; h = (it >> 4) & 7; b = it >> 7; qtok0 = b * 256 + qb * 16; }
    const bf16_t* qrow = QKV + (size_t)(qtok0 + fr) * 1536 + h * 64;
    const bf16x8 qf0 = *(const bf16x8*)(qrow + 8 * fq), qf1 = *(const bf16x8*)(qrow + 32 + 8 * fq);
    const int row_start = min(max(r - 4, 0), 8), kb_start = min(max(16 * j - 8, 0), 32);
    const int qcol = 16 * j + fr, col_start = min(max(qcol - 8, 0), 48);
    const float* rpb = P.in[I_RPB] + ((size_t)layer * 8 + h) * 15 * 31;
    float m = -INFINITY, lsum = 0.f;
    f32x4 o[4];
#pragma unroll
    for (int dt = 0; dt < 4; ++dt) o[dt] = (f32x4){0.f, 0.f, 0.f, 0.f};
    const int nch = latent ? 16 : 8;
    for (int c = 0; c < nch; ++c) {
        const bf16_t* kb; const bf16_t* vb; int stride;
        if (!latent) { kb = QKV + (size_t)(b * 256 + 32 * c) * 1536 + 512 + h * 64; vb = kb + 512; stride = 1536; }
        else if (c < 8) { const size_t off = ((size_t)(b * 4 + layer) * 256 + 32 * c) * 512 + h * 64; kb = (const bf16_t*)(P.ws + OFF_CKB) + off; vb = (const bf16_t*)(P.ws + OFF_CVB) + off; stride = 512; }
        else { const int tok = NCTX + b * 1024 + (row_start + (c - 8)) * 64 + kb_start; kb = QKV + (size_t)tok * 1536 + 512 + h * 64; vb = kb + 512; stride = 1536; }
        LAS unsigned char* kl = wl + (c & 1) * 8192; LAS unsigned char* vl = kl + 4096;
        u32x4 kr[4], vr[4];
#pragma unroll
        for (int i = 0; i < 4; ++i) { const int idx = i * 64 + lane, key = idx >> 3, chn = idx & 7;
            kr[i] = *(const u32x4*)(kb + (size_t)key * stride + chn * 8); vr[i] = *(const u32x4*)(vb + (size_t)key * stride + chn * 8); }
#pragma unroll
        for (int i = 0; i < 4; ++i) { const int idx = i * 64 + lane, key = idx >> 3, chn = idx & 7; const int off = key * 128 + ((chn ^ (key & 7)) << 4);
            *(LAS u32x4*)(kl + off) = kr[i]; *(LAS u32x4*)(vl + off) = vr[i]; }
        LDS_WAIT();
        f32x4 st[2];
#pragma unroll
        for (int kt = 0; kt < 2; ++kt) {
            const bf16x8 k0 = *(const LAS bf16x8*)(kl + (16 * kt + fr) * 128 + (((fq) ^ (fr & 7)) << 4));
            const bf16x8 k1 = *(const LAS bf16x8*)(kl + (16 * kt + fr) * 128 + (((4 + fq) ^ (fr & 7)) << 4));
            f32x4 s = {0.f, 0.f, 0.f, 0.f};
            s = __builtin_amdgcn_mfma_f32_16x16x32_bf16(k0, qf0, s, 0, 0, 0);
            s = __builtin_amdgcn_mfma_f32_16x16x32_bf16(k1, qf1, s, 0, 0, 0);
            st[kt] = s;
        }
        if (latent && c >= 8) {
            const int dr = row_start + (c - 8) - r + 7;
#pragma unroll
            for (int kt = 0; kt < 2; ++kt)
#pragma unroll
                for (int e = 0; e < 4; ++e) { const int kc = kb_start + 16 * kt + 4 * fq + e; const bool valid = (kc >= col_start) && (kc < col_start + 16);
                    const int dc = min(max(kc - qcol + 15, 0), 30);
                    st[kt][e] = valid ? st[kt][e] + rpb[dr * 31 + dc] : -1e30f; }
        }
        float cm = fmaxf(fmaxf(fmaxf(st[0].x, st[0].y), fmaxf(st[0].z, st[0].w)), fmaxf(fmaxf(st[1].x, st[1].y), fmaxf(st[1].z, st[1].w)));
        cm = fmaxf(cm, __shfl_xor(cm, 16)); cm = fmaxf(cm, __shfl_xor(cm, 32));
        const float mn = fmaxf(m, cm), al = __expf(m - mn);
        m = mn;
        float ps = 0.f;
#pragma unroll
        for (int kt = 0; kt < 2; ++kt)
#pragma unroll
            for (int e = 0; e < 4; ++e) { st[kt][e] = __expf(st[kt][e] - mn); ps += st[kt][e]; }
        lsum = lsum * al + ps;
        const u32x4 pw = {cvtpk(st[0].x, st[0].y), cvtpk(st[0].z, st[0].w), cvtpk(st[1].x, st[1].y), cvtpk(st[1].z, st[1].w)};
        const bf16x8 pf = __builtin_bit_cast(bf16x8, pw);
        const int ka = 4 * fq + (fr >> 2), kb2 = ka + 16;
#pragma unroll
        for (int dt = 0; dt < 4; ++dt) {
            const int chn = 2 * dt + ((fr & 3) >> 1), half = (fr & 1) << 3;
            const s16x4 v0 = __builtin_amdgcn_ds_read_tr16_b64_v4i16((LAS s16x4*)(vl + ka * 128 + ((chn ^ (ka & 7)) << 4) + half));
            const s16x4 v1 = __builtin_amdgcn_ds_read_tr16_b64_v4i16((LAS s16x4*)(vl + kb2 * 128 + ((chn ^ (kb2 & 7)) << 4) + half));
            const bf16x8 vf = {v0[0], v0[1], v0[2], v0[3], v1[0], v1[1], v1[2], v1[3]};
            o[dt] = o[dt] * al;
            o[dt] = __builtin_amdgcn_mfma_f32_16x16x32_bf16(vf, pf, o[dt], 0, 0, 0);
        }
        LDS_WAIT();
    }
    lsum += __shfl_xor(lsum, 16); lsum += __shfl_xor(lsum, 32);
    const float inv = 1.0f / lsum;
    bf16_t* orow = AO + (size_t)(qtok0 + fr) * 512 + h * 64 + 4 * fq;
#pragma unroll
    for (int dt = 0; dt < 4; ++dt) { const f32x4 a = o[dt] * inv; *(u32x2*)(orow + 16 * dt) = (u32x2){cvtpk(a.x, a.y), cvtpk(a.z, a.w)}; }
}

__device__ __forceinline__ void phase_mixers(const Params& P, int layer, LAS unsigned char* lds) {
    for (int it = obid(); it < 384 + 192; it += GRID) {
        if (it < 384) conv_item(P, layer, it, lds); else gating_item(P, layer, it - 384, lds);
    }
    __syncthreads();
    const int tid = otid(), wid = tid >> 6, lane = tid & 63;
    unsigned* ctr = (unsigned*)(P.ws + OFF_CTL) + CW_ATTCTR + 64 * layer;
    LAS unsigned char* wl = lds + wid * 16384;
    for (;;) {
        int item = 0;
        if (lane == 0) item = (int)atomicAdd(ctr, 1u);
        item = __builtin_amdgcn_readfirstlane(item);
        if (item >= 3072) break;
        attn_item(P, layer, item, wl, lane);
    }
}

__device__ __forceinline__ void phase_merge(const Params& P, int layer, LAS unsigned char* lds) {
    const int tid = otid(), wid = tid >> 6, lane = tid & 63, fr = lane & 15, fq = lane >> 4, wm = wid >> 1, wn = wid & 1;
    const bf16_t* AM = (const bf16_t*)(P.ws + OFF_AMIX);
    const bf16_t* WP = (const bf16_t*)(P.ws + OFF_WPW) + (size_t)layer * 3 * D * 512;
    const bf16_t* GATES = (const bf16_t*)(P.ws + OFF_GATES);
    bf16_t* MG = (bf16_t*)(P.ws + OFF_MERGED);
    for (int T = obid(); T < 256; T += GRID) {
        const int pm = T >> 3, pn = T & 7, m0 = pm * 192, n0 = pn * 128;
        f32x4 tot[3][4]; zero_acc<3>(tot);
        for (int b = 0; b < 3; ++b) {
            f32x4 acc[3][4]; zero_acc<3>(acc);
            const bf16_t* A = AM + (size_t)b * NT * 512; const bf16_t* W = WP + (size_t)b * D * 512;
            gemm_loop<3>(acc, lds, [&](int r) { return A + (size_t)(m0 + r) * 512; }, [&](int n) { return W + (size_t)(n0 + n) * 512; }, 512 / 64, tid);
#pragma unroll
            for (int mt = 0; mt < 3; ++mt) { const bf16_t* gp = GATES + (size_t)(m0 + wm * 48 + mt * 16 + fr) * 3072 + b * 1024 + n0 + wn * 64 + 4 * fq;
#pragma unroll
                for (int nt = 0; nt < 4; ++nt) { const u32x2 g = *(const u32x2*)(gp + nt * 16);
                    tot[mt][nt] += acc[mt][nt] * (f32x4){bflo(g.x), bfhi(g.x), bflo(g.y), bfhi(g.y)}; } }
        }
#pragma unroll
        for (int mt = 0; mt < 3; ++mt) { bf16_t* o = MG + (size_t)(m0 + wm * 48 + mt * 16 + fr) * D + n0 + wn * 64 + 4 * fq;
#pragma unroll
            for (int nt = 0; nt < 4; ++nt) *(u32x2*)(o + nt * 16) = (u32x2){cvtpk(tot[mt][nt].x, tot[mt][nt].y), cvtpk(tot[mt][nt].z, tot[mt][nt].w)}; }
    }
}

__device__ __forceinline__ void phase_wo(const Params& P, int layer, LAS unsigned char* lds) {
    const int tid = otid(), wid = tid >> 6, lane = tid & 63, fr = lane & 15, fq = lane >> 4, wm = wid >> 1, wn = wid & 1;
    const bf16_t* MG = (const bf16_t*)(P.ws + OFF_MERGED);
    const bf16_t* W = (const bf16_t*)(P.ws + OFF_WO) + (size_t)layer * D * D;
    const float* MOD = (const float*)(P.ws + OFF_MOD);
    float* X = P.out;
    for (int T = obid(); T < 256; T += GRID) {
        const int pm = T >> 3, pn = T & 7, m0 = pm * 192, n0 = pn * 128;
        f32x4 acc[3][4]; zero_acc<3>(acc);
        gemm_loop<3>(acc, lds, [&](int r) { return MG + (size_t)(m0 + r) * D; }, [&](int n) { return W + (size_t)(n0 + n) * D; }, D / 64, tid);
#pragma unroll
        for (int mt = 0; mt < 3; ++mt) { const int t = m0 + wm * 48 + mt * 16 + fr, c = n0 + wn * 64 + 4 * fq;
            const float* g1 = MOD + ((size_t)layer * 3 + mvec_of(t)) * 6144 + 2 * D + c; float* x = X + (size_t)t * D + c;
#pragma unroll
            for (int nt = 0; nt < 4; ++nt) { const f32x4 xv = *(const f32x4*)(x + nt * 16), g = *(const f32x4*)(g1 + nt * 16); *(f32x4*)(x + nt * 16) = xv * ALPHA + g * acc[mt][nt]; } }
    }
}

__device__ __forceinline__ void phase_ln1_router(const Params& P, int layer) {
    const int tid = otid(), wid = tid >> 6, lane = tid & 63;
    const int gw = obid() * NWAVES + wid;
    float* X = P.out; bf16_t* H = (bf16_t*)(P.ws + OFF_H);
    const float* MOD = (const float*)(P.ws + OFF_MOD);
    const float* lg = P.in[I_LN1G] + layer * D; const float* lb = P.in[I_LN1B] + layer * D;
    const float* rgw = P.in[I_RGW] + (size_t)layer * D * 4; const float* rew = P.in[I_REW] + (size_t)layer * 4 * D * 8;
    unsigned* cnt = (unsigned*)(P.ws + OFF_CTL) + CW_MOECNT + layer * 32;
    int2* LIST = (int2*)(P.ws + OFF_LIST);
    for (int t = gw; t < NT; t += NGW) {
        const int mv = mvec_of(t);
        f32x4 v[4]; float s = 0.f;
#pragma unroll
        for (int j = 0; j < 4; ++j) { v[j] = *(const f32x4*)(X + (size_t)t * D + 4 * lane + 256 * j); s += (v[j].x + v[j].y) + (v[j].z + v[j].w); }
        const float mean = wave_sum(s) * (1.f / D); float q = 0.f;
#pragma unroll
        for (int j = 0; j < 4; ++j) { v[j] = v[j] - mean; q += (v[j].x * v[j].x + v[j].y * v[j].y) + (v[j].z * v[j].z + v[j].w * v[j].w); }
        const float rstd = rsqrtf(wave_sum(q) * (1.f / D) + LN_EPS);
        const float* sh = MOD + ((size_t)layer * 3 + mv) * 6144 + 3 * D; const float* sc = sh + D;
        f32x4 hv[4];
#pragma unroll
        for (int j = 0; j < 4; ++j) { const int c = 4 * lane + 256 * j;
            v[j] = v[j] * rstd * *(const f32x4*)(lg + c) + *(const f32x4*)(lb + c);
            *(f32x4*)(X + (size_t)t * D + c) = v[j];
            hv[j] = v[j] * (*(const f32x4*)(sc + c) + 1.0f) + *(const f32x4*)(sh + c);
            *(u32x2*)(H + (size_t)t * D + c) = (u32x2){cvtpk(hv[j].x, hv[j].y), cvtpk(hv[j].z, hv[j].w)}; }
        f32x4 ga = {0.f, 0.f, 0.f, 0.f};
#pragma unroll
        for (int j = 0; j < 4; ++j)
#pragma unroll
            for (int e = 0; e < 4; ++e) ga += *(const f32x4*)(rgw + (size_t)(4 * lane + 256 * j + e) * 4) * hv[j][e];
        float gl[4];
#pragma unroll
        for (int g = 0; g < 4; ++g) gl[g] = wave_sum(ga[g]) + P.in[I_RGB][layer * 4 + g];
        int gi = 0; float gm = gl[0];
#pragma unroll
        for (int g = 1; g < 4; ++g) if (gl[g] > gm) { gm = gl[g]; gi = g; }
        float gs = 0.f;
#pragma unroll
        for (int g = 0; g < 4; ++g) gs += __expf(gl[g] - gm);
        const float gp = 1.0f / gs;
        gi = __builtin_amdgcn_readfirstlane(gi);
        const float* rw = rew + (size_t)gi * D * 8;
        f32x4 e0 = {0.f, 0.f, 0.f, 0.f}, e1 = e0;
#pragma unroll
        for (int j = 0; j < 4; ++j)
#pragma unroll
            for (int e = 0; e < 4; ++e) { const float* wp = rw + (size_t)(4 * lane + 256 * j + e) * 8; e0 += *(const f32x4*)(wp) * hv[j][e]; e1 += *(const f32x4*)(wp + 4) * hv[j][e]; }
        float es[8];
#pragma unroll
        for (int e = 0; e < 4; ++e) { es[e] = wave_sum(e0[e]) + P.in[I_REB][(layer * 4 + gi) * 8 + e]; es[4 + e] = wave_sum(e1[e]) + P.in[I_REB][(layer * 4 + gi) * 8 + 4 + e]; }
        int i1 = 0; float v1 = es[0];
#pragma unroll
        for (int e = 1; e < 8; ++e) if (es[e] > v1) { v1 = es[e]; i1 = e; }
        int i2 = -1; float v2 = -INFINITY;
#pragma unroll
        for (int e = 0; e < 8; ++e) if (e != i1 && es[e] > v2) { v2 = es[e]; i2 = e; }
        const float ex = __expf(v2 - v1), w1 = gp / (1.0f + ex), w2 = gp * ex / (1.0f + ex);
        if (lane < 2) { const int ei = gi * 8 + (lane == 0 ? i1 : i2); const float w = (lane == 0) ? w1 : w2;
            const unsigned pos = atomicAdd(cnt + ei, 1u);
            LIST[(size_t)ei * NT + pos] = make_int2(t | (lane << 16), __float_as_int(w)); }
    }
}

__device__ __forceinline__ void phase_moe(const Params& P, int layer, LAS unsigned char* lds) {
    const int tid = otid(), wid = tid >> 6, lane = tid & 63, fr = lane & 15, fq = lane >> 4;
    const bf16_t* H = (const bf16_t*)(P.ws + OFF_H);
    bf16_t* Y = (bf16_t*)(P.ws + OFF_Y);
    const unsigned* cnt = (const unsigned*)(P.ws + OFF_CTL) + CW_MOECNT + layer * 32;
    const int2* LIST = (const int2*)(P.ws + OFF_LIST);
    constexpr int STAGE = 8192 + 32768;
    LAS unsigned char* hid = lds + 2 * STAGE;
    const int rr = lane >> 3, lc = (lane & 7) ^ rr;
    int total = 0;
    for (int e = 0; e < 32; ++e) total += ((int)cnt[e] + 63) >> 6;
    for (int T = obid(); T < total; T += GRID) {
        int e = 0, rb = T;
        for (;;) { const int n = ((int)cnt[e] + 63) >> 6; if (rb < n) break; rb -= n; ++e; }
        const int ce = (int)cnt[e], nrows = min(64, ce - rb * 64);
        const int2* lst = LIST + (size_t)e * NT + rb * 64;
        const bf16_t* ap; const bf16_t* bp[4];
        { const int row = wid * 8 + rr; const int tok = lst[min(row, nrows - 1)].x & 0xffff; ap = H + (size_t)tok * D + lc * 8; }
        const bf16_t* W13 = (const bf16_t*)(P.ws + OFF_W13) + ((size_t)layer * 32 + e) * 256 * D;
#pragma unroll
        for (int i = 0; i < 4; ++i) bp[i] = W13 + (size_t)((wid + 8 * i) * 8 + rr) * D + lc * 8;
        f32x4 acc[4][2];
#pragma unroll
        for (int mt = 0; mt < 4; ++mt) { acc[mt][0] = (f32x4){0.f, 0.f, 0.f, 0.f}; acc[mt][1] = acc[mt][0]; }
        __syncthreads();
#define MOE_STAGE1(kt, buf) do { LAS unsigned char* sa_ = lds + (buf) * STAGE; glds16(ap + (kt) * 64, sa_ + wid * 1024); \
        _Pragma("unroll") for (int i = 0; i < 4; ++i) glds16(bp[i] + (kt) * 64, sa_ + 8192 + (wid + 8 * i) * 1024); } while (0)
        MOE_STAGE1(0, 0);
        for (int kt = 0; kt < 16; ++kt) {
            VM_WAIT(); __syncthreads();
            if (kt + 1 < 16) MOE_STAGE1(kt + 1, (kt + 1) & 1);
            LAS unsigned char* sa = lds + (kt & 1) * STAGE; LAS unsigned char* sb = sa + 8192;
#pragma unroll
            for (int ks = 0; ks < 2; ++ks) { const int sw = ((ks * 4 + fq) ^ (fr & 7)) * 16;
                bf16x8 a[4];
#pragma unroll
                for (int mt = 0; mt < 4; ++mt) a[mt] = *(const LAS bf16x8*)(sa + (mt * 16 + fr) * 128 + sw);
                const bf16x8 b0 = *(const LAS bf16x8*)(sb + (wid * 16 + fr) * 128 + sw), b1 = *(const LAS bf16x8*)(sb + (128 + wid * 16 + fr) * 128 + sw);
#pragma unroll
                for (int mt = 0; mt < 4; ++mt) { acc[mt][0] = __builtin_amdgcn_mfma_f32_16x16x32_bf16(b0, a[mt], acc[mt][0], 0, 0, 0); acc[mt][1] = __builtin_amdgcn_mfma_f32_16x16x32_bf16(b1, a[mt], acc[mt][1], 0, 0, 0); } }
        }
#undef MOE_STAGE1
        int tokslot[4]; float wgt[4];
#pragma unroll
        for (int mt = 0; mt < 4; ++mt) { const int row = mt * 16 + fr; const int2 en = lst[min(row, nrows - 1)]; tokslot[mt] = (row < nrows) ? en.x : -1; wgt[mt] = __int_as_float(en.y); }
#pragma unroll
        for (int mt = 0; mt < 4; ++mt) { const int row = mt * 16 + fr; const f32x4 h1 = acc[mt][0], h3 = acc[mt][1]; const float w = wgt[mt];
            const u32x2 o = {cvtpk(siluf_(h1.x) * h3.x * w, siluf_(h1.y) * h3.y * w), cvtpk(siluf_(h1.z) * h3.z * w, siluf_(h1.w) * h3.w * w)};
            const int chn = 2 * (wid & 3) + (fq >> 1);
            *(LAS u32x2*)(hid + (wid >> 2) * 8192 + row * 128 + ((chn ^ (row & 7)) << 4) + ((fq & 1) << 3)) = o; }
        __syncthreads();
        const bf16_t* W2 = (const bf16_t*)(P.ws + OFF_W2) + ((size_t)layer * 32 + e) * D * 128;
#define MOE_STAGE2(st, buf) do { LAS unsigned char* sb_ = lds + (buf) * STAGE + 8192; const int nc_ = (st) >> 1, k2_ = (st) & 1; \
        _Pragma("unroll") for (int i = 0; i < 4; ++i) glds16(W2 + (size_t)(nc_ * 256 + (wid + 8 * i) * 8 + rr) * 128 + k2_ * 64 + lc * 8, sb_ + (wid + 8 * i) * 1024); } while (0)
        MOE_STAGE2(0, 0);
        f32x4 acc2[4][2];
        for (int st = 0; st < 8; ++st) {
            VM_WAIT(); __syncthreads();
            if (st + 1 < 8) MOE_STAGE2(st + 1, (st + 1) & 1);
            const int nc = st >> 1, k2 = st & 1;
            if (k2 == 0) {
#pragma unroll
                for (int mt = 0; mt < 4; ++mt) { acc2[mt][0] = (f32x4){0.f, 0.f, 0.f, 0.f}; acc2[mt][1] = acc2[mt][0]; } }
            LAS unsigned char* sb = lds + (st & 1) * STAGE + 8192; LAS unsigned char* sa = hid + k2 * 8192;
#pragma unroll
            for (int ks = 0; ks < 2; ++ks) { const int sw = ((ks * 4 + fq) ^ (fr & 7)) * 16;
                bf16x8 a[4];
#pragma unroll
                for (int mt = 0; mt < 4; ++mt) a[mt] = *(const LAS bf16x8*)(sa + (mt * 16 + fr) * 128 + sw);
                const bf16x8 b0 = *(const LAS bf16x8*)(sb + (wid * 32 + fr) * 128 + sw), b1 = *(const LAS bf16x8*)(sb + (wid * 32 + 16 + fr) * 128 + sw);
#pragma unroll
                for (int mt = 0; mt < 4; ++mt) { acc2[mt][0] = __builtin_amdgcn_mfma_f32_16x16x32_bf16(b0, a[mt], acc2[mt][0], 0, 0, 0); acc2[mt][1] = __builtin_amdgcn_mfma_f32_16x16x32_bf16(b1, a[mt], acc2[mt][1], 0, 0, 0); } }
            if (k2 == 1) {
#pragma unroll
                for (int mt = 0; mt < 4; ++mt) if (tokslot[mt] >= 0) { const int tok = tokslot[mt] & 0xffff, slot = tokslot[mt] >> 16;
                    bf16_t* o = Y + ((size_t)slot * NT + tok) * D + nc * 256 + wid * 32 + 4 * fq;
                    *(u32x2*)(o) = (u32x2){cvtpk(acc2[mt][0].x, acc2[mt][0].y), cvtpk(acc2[mt][0].z, acc2[mt][0].w)};
                    *(u32x2*)(o + 16) = (u32x2){cvtpk(acc2[mt][1].x, acc2[mt][1].y), cvtpk(acc2[mt][1].z, acc2[mt][1].w)}; } }
        }
#undef MOE_STAGE2
        __syncthreads();
    }
}

constexpr int N_PHASES = 2 + 7 * NLAYER;
__global__ void __launch_bounds__(NTHREADS, 2) hybrid_fwd(Params P) {
    extern __shared__ __attribute__((aligned(16))) unsigned char lds_raw[];
    LAS unsigned char* lds = (LAS unsigned char*)lds_raw;
    volatile LAS unsigned* MISC = (volatile LAS unsigned*)(lds + LDS_BYTES - 64);
    if (threadIdx.x < 16) MISC[threadIdx.x] = 0u;
    __syncthreads();
    XcdBarrier bar; bar.bar = (unsigned*)(P.ws + OFF_CTL) + CW_BAR; bar.x = 0; bar.st = MISC;
    const bool multi = (P.ph_hi - P.ph_lo) > 1;
    if (multi) bar = xcd_barrier_post((unsigned*)(P.ws + OFF_CTL) + CW_BAR, MISC);
    for (int ph = P.ph_lo; ph < P.ph_hi; ++ph) {
        if (ph == 0) phase_prologue(P, lds);
        else if (ph == 1) phase_rows_final(P, 0);
        else {
            const int layer = (ph - 2) / 7, sub = (ph - 2) % 7;
            if (sub == 0) phase_win(P, layer, lds);
            else if (sub == 1) phase_mixers(P, layer, lds);
            else if (sub == 2) phase_merge(P, layer, lds);
            else if (sub == 3) phase_wo(P, layer, lds);
            else if (sub == 4) phase_ln1_router(P, layer);
            else if (sub == 5) phase_moe(P, layer, lds);
            else phase_rows_final(P, layer + 1);
        }
        if (ph + 1 < P.ph_hi) xcd_barrier(bar);
    }
}

extern "C" void kernel_launch(void* const* d_in, const int* in_sizes, int n_in, void* d_out, int out_size, void* d_ws, size_t ws_size, hipStream_t stream) {
    static int ready = 0;
    if (ready == 0) {
        ready = 1;
        if (n_in != 33 || ws_size < WS_END) { fprintf(stderr, "kernel_launch: need 33 inputs and %zu bytes of workspace (got %d, %zu)\n", (size_t)WS_END, n_in, ws_size); ready = -1; }
        else if (hipFuncSetAttribute((const void*)hybrid_fwd, hipFuncAttributeMaxDynamicSharedMemorySize, LDS_BYTES) != hipSuccess) { fprintf(stderr, "kernel_launch: hipFuncSetAttribute failed\n"); ready = -1; }
    }
    if (ready < 0) return;
    (void)hipMemsetAsync((char*)d_ws + OFF_CTL, 0, CTL_BYTES, stream);
    Params p{};
    for (int i = 0; i < 33; ++i) p.in[i] = (const float*)d_in[i];
    p.out = (float*)d_out; p.ws = (unsigned char*)d_ws;
#if MK_MULTI
    for (int ph = 0; ph < N_PHASES; ++ph) { p.ph_lo = ph; p.ph_hi = ph + 1; hipLaunchKernelGGL(hybrid_fwd, dim3(GRID), dim3(NTHREADS), LDS_BYTES, stream, p); }
#else
    p.ph_lo = 0; p.ph_hi = N_PHASES;
    hipLaunchKernelGGL(hybrid_fwd, dim3(GRID), dim3(NTHREADS), LDS_BYTES, stream, p);
#endif
}
```
